# Optimizing an MI355X kernel written in HIP

```python
import jax, jax.numpy as jnp
from jax import lax
import numpy as np

D_MODEL = 1024
BATCH = 4
SEQ = 4096
DEPTH = 1

CHUNK = 64
D_MIX = D_MODEL
HG_WIDTH = D_MIX // 2
HG_HEAD_DIM = 128
HG_HEADS = HG_WIDTH // HG_HEAD_DIM
SSD_WIDTH = D_MIX - HG_WIDTH
SSD_HEAD_DIM = 64
SSD_HEADS = SSD_WIDTH // SSD_HEAD_DIM
SSD_GROUPS = 2
SSD_STATE = 128
SSD_CONV = 4
SSD_CONV_DIM = SSD_WIDTH + 2 * SSD_GROUPS * SSD_STATE
SPLITS = (HG_WIDTH, 2 * HG_WIDTH, 3 * HG_WIDTH, 4 * HG_WIDTH,
          4 * HG_WIDTH + SSD_WIDTH, 4 * HG_WIDTH + SSD_WIDTH + SSD_CONV_DIM)
IN_COLS = 4 * HG_WIDTH + SSD_WIDTH + SSD_CONV_DIM + SSD_HEADS
N_EXPERTS = 32
TOP_K = 4
D_EXPERT = D_MODEL
SWIGLU_LIMIT = 7.0
SWIGLU_ALPHA = 1.702
EXPERT_BLOCK = 256
DEEPNORM_ALPHA = (2 * DEPTH) ** 0.25
DEEPNORM_BETA = (8 * DEPTH) ** -0.25
LN_EPS = 1e-5
RMS_EPS = 1e-5

kernel_name = 'hybrid_hgrn2_ssd_moe_deepnorm'


def layer_norm(x, g, b):
    xf = x.astype(jnp.float32)
    mu = jnp.mean(xf, -1, keepdims=True)
    var = jnp.mean(jnp.square(xf - mu), -1, keepdims=True)
    y = (xf - mu) * lax.rsqrt(var + LN_EPS) * g.astype(jnp.float32) + b.astype(jnp.float32)
    return y.astype(x.dtype)


def rms_norm(x, w):
    xf = x.astype(jnp.float32)
    return xf * lax.rsqrt(jnp.mean(jnp.square(xf), -1, keepdims=True) + RMS_EPS) * w.astype(jnp.float32)


def hgrn2_mixer(q_raw, f_raw, i_raw, g_raw, lb, norm_w):
    f32 = jnp.float32
    Bsz, L, _ = q_raw.shape
    N = L // CHUNK
    q = jax.nn.silu(q_raw.astype(f32))
    f = lb + (1.0 - lb) * jax.nn.sigmoid(f_raw.astype(f32))
    log_f = jnp.log(f)
    k = 1.0 - f
    v = i_raw.astype(f32)

    def to_chunks(t):
        return t.reshape(Bsz, N, CHUNK, HG_HEADS, HG_HEAD_DIM).transpose(1, 0, 3, 2, 4)

    causal = jnp.tril(jnp.ones((CHUNK, CHUNK), dtype=bool))

    def step(S, inp):
        qc, kc, vc, lfc = inp
        b = jnp.cumsum(lfc, axis=2)
        rel = jnp.where(causal[:, :, None], b[:, :, :, None, :] - b[:, :, None, :, :], -jnp.inf)
        scores = jnp.einsum('bhtk,bhtsk,bhsk->bhts', qc, jnp.exp(rel), kc)
        o = scores @ vc + jnp.einsum('bhtk,bhkv->bhtv', qc * jnp.exp(b), S)
        b_end = b[:, :, -1:, :]
        S = jnp.exp(b_end[:, :, 0, :, None]) * S + jnp.einsum('bhsk,bhsv->bhkv', kc * jnp.exp(b_end - b), vc)
        return S, o

    S0 = jnp.zeros((Bsz, HG_HEADS, HG_HEAD_DIM, HG_HEAD_DIM), f32)
    _, o = lax.scan(step, S0, (to_chunks(q), to_chunks(k), to_chunks(v), to_chunks(log_f)))
    o = o.transpose(1, 0, 3, 2, 4).reshape(Bsz, L, HG_HEADS, HG_HEAD_DIM)
    o = rms_norm(o, norm_w).reshape(Bsz, L, HG_WIDTH)
    return o * jax.nn.silu(g_raw.astype(f32))


def ssd_mixer(z, xbc, dt_raw, conv_w, conv_b, dt_bias, a_log, d_skip, norm_w):
    f32 = jnp.float32
    Bsz, L, _ = z.shape
    N = L // CHUNK
    xbc = lax.conv_general_dilated(xbc.astype(f32), conv_w.astype(f32)[:, None, :], window_strides=(1,),
                                   padding=[(SSD_CONV - 1, 0)], dimension_numbers=('NWC', 'WIO', 'NWC'),
                                   feature_group_count=SSD_CONV_DIM)
    xbc = jax.nn.silu(xbc + conv_b.astype(f32))
    xs, Bm, Cm = jnp.split(xbc, [SSD_WIDTH, SSD_WIDTH + SSD_GROUPS * SSD_STATE], axis=-1)
    rep = SSD_HEADS // SSD_GROUPS
    xs = xs.reshape(Bsz, N, CHUNK, SSD_HEADS, SSD_HEAD_DIM)
    Bm = jnp.repeat(Bm.reshape(Bsz, N, CHUNK, SSD_GROUPS, SSD_STATE), rep, axis=3)
    Cm = jnp.repeat(Cm.reshape(Bsz, N, CHUNK, SSD_GROUPS, SSD_STATE), rep, axis=3)
    dt = jax.nn.softplus(dt_raw.astype(f32) + dt_bias.astype(f32)).reshape(Bsz, N, CHUNK, SSD_HEADS)
    A = -jnp.exp(a_log.astype(f32))
    cs = jnp.cumsum((dt * A).transpose(0, 3, 1, 2), axis=-1)
    xdt = xs * dt[..., None]
    causal = jnp.tril(jnp.ones((CHUNK, CHUNK), dtype=bool))
    seg = jnp.where(causal, cs[..., :, None] - cs[..., None, :], -jnp.inf)
    y_diag = jnp.einsum('bclhn,bcshn,bhcls,bcshp->bclhp', Cm, Bm, jnp.exp(seg), xdt)
    states = jnp.einsum('bclhn,bhcl,bclhp->bchpn', Bm, jnp.exp(cs[..., -1:] - cs), xdt)
    chunk_decay = jnp.exp(cs[..., -1])

    def pass_state(h, inp):
        s, a = inp
        return a[..., None, None] * h + s, h

    h0 = jnp.zeros((Bsz, SSD_HEADS, SSD_HEAD_DIM, SSD_STATE), f32)
    _, prev = lax.scan(pass_state, h0, (states.transpose(1, 0, 2, 3, 4), chunk_decay.transpose(2, 0, 1)))
    prev = prev.transpose(1, 0, 2, 3, 4)
    y_off = jnp.einsum('bclhn,bchpn,bhcl->bclhp', Cm, prev, jnp.exp(cs))
    y = y_diag + y_off + xs * d_skip.astype(f32)[:, None]
    y = y.reshape(Bsz, L, SSD_WIDTH) * jax.nn.silu(z.astype(f32))
    y = rms_norm(y.reshape(Bsz, L, SSD_GROUPS, -1), norm_w.reshape(SSD_GROUPS, -1))
    return y.reshape(Bsz, L, SSD_WIDTH)


def moe_ffn(x, router_w, router_b, w_gate, b_gate, w_up, b_up, w_down, b_down):
    f32 = jnp.float32
    Bsz, L, D = x.shape
    T = Bsz * L
    xt = x.reshape(T, D)
    logits = (xt @ router_w + router_b).astype(f32)
    top_val, top_idx = lax.top_k(logits, TOP_K)
    gates = jax.nn.softmax(top_val, axis=-1)
    n_assign = T * TOP_K
    n_blocks = n_assign // EXPERT_BLOCK + N_EXPERTS
    cap = n_blocks * EXPERT_BLOCK
    flat_e = top_idx.reshape(-1)
    order = jnp.argsort(flat_e)
    sorted_e = flat_e[order]
    counts = jnp.bincount(flat_e, length=N_EXPERTS)
    offsets = jnp.cumsum(counts) - counts
    padded = (counts + EXPERT_BLOCK - 1) // EXPERT_BLOCK * EXPERT_BLOCK
    padded_end = jnp.cumsum(padded)
    padded_start = padded_end - padded
    dest = padded_start[sorted_e] + jnp.arange(n_assign) - offsets[sorted_e]
    row_tok = jnp.zeros((cap,), jnp.int32).at[dest].set((order // TOP_K).astype(jnp.int32))
    row_gate = jnp.zeros((cap,), f32).at[dest].set(gates.reshape(-1)[order])
    block_expert = jnp.minimum(jnp.searchsorted(padded_end, jnp.arange(n_blocks) * EXPERT_BLOCK, side='right'),
                               N_EXPERTS - 1)
    x_rows = xt[row_tok].reshape(n_blocks, EXPERT_BLOCK, D)

    def expert_block(args):
        xb, e = args
        hg = jnp.minimum(xb @ w_gate[e] + b_gate[e], SWIGLU_LIMIT)
        hu = jnp.clip(xb @ w_up[e] + b_up[e], -SWIGLU_LIMIT, SWIGLU_LIMIT)
        h = (hu + 1.0) * (hg * jax.nn.sigmoid(SWIGLU_ALPHA * hg))
        return h @ w_down[e] + b_down[e]

    y_rows = lax.map(expert_block, (x_rows, block_expert)).reshape(cap, D)
    out = jnp.zeros((T, D), f32).at[row_tok].add(y_rows.astype(f32) * row_gate[:, None])
    return out.reshape(Bsz, L, D).astype(x.dtype)


def setup_inputs(seed: int = 0) -> dict:
    key = jax.random.key(seed)
    ks = jax.random.split(key, 24)
    f32 = jnp.float32
    nrm = lambda k, s: jax.random.normal(k, s, f32)
    col_scale = np.ones((IN_COLS,), np.float32)
    col_scale[2 * HG_WIDTH:3 * HG_WIDTH] = DEEPNORM_BETA
    col_scale[4 * HG_WIDTH + SSD_WIDTH:4 * HG_WIDTH + 2 * SSD_WIDTH] = DEEPNORM_BETA
    dt0 = jnp.exp(jax.random.uniform(ks[6], (DEPTH, SSD_HEADS), f32) * (np.log(0.1) - np.log(1e-3)) + np.log(1e-3))
    return {
        'x': nrm(ks[0], (BATCH, SEQ, D_MODEL)),
        'w_in': nrm(ks[1], (DEPTH, D_MODEL, IN_COLS)) * D_MODEL ** -0.5 * jnp.asarray(col_scale),
        'hg_lower_bound': 0.1 * nrm(ks[2], (DEPTH + 1, HG_WIDTH)),
        'hg_norm_w': 1.0 + 0.02 * nrm(ks[3], (DEPTH, HG_HEAD_DIM)),
        'conv_w': nrm(ks[4], (DEPTH, SSD_CONV, SSD_CONV_DIM)) * SSD_CONV ** -0.5,
        'conv_b': 0.02 * nrm(ks[5], (DEPTH, SSD_CONV_DIM)),
        'dt_bias': dt0 + jnp.log(-jnp.expm1(-dt0)),
        'a_log': jnp.log(jax.random.uniform(ks[7], (DEPTH, SSD_HEADS), f32, 1.0, 16.0)),
        'd_skip': 1.0 + 0.02 * nrm(ks[8], (DEPTH, SSD_HEADS)),
        'ssd_norm_w': 1.0 + 0.02 * nrm(ks[9], (DEPTH, SSD_WIDTH)),
        'w_out': nrm(ks[10], (DEPTH, D_MIX, D_MODEL)) * D_MIX ** -0.5 * DEEPNORM_BETA,
        'ln1_g': 1.0 + 0.02 * nrm(ks[11], (DEPTH, D_MODEL)),
        'ln1_b': 0.02 * nrm(ks[12], (DEPTH, D_MODEL)),
        'router_w': nrm(ks[13], (DEPTH, D_MODEL, N_EXPERTS)) * D_MODEL ** -0.5,
        'router_b': 0.01 * nrm(ks[14], (DEPTH, N_EXPERTS)),
        'w_gate': nrm(ks[15], (DEPTH, N_EXPERTS, D_MODEL, D_EXPERT)) * D_MODEL ** -0.5 * DEEPNORM_BETA,
        'b_gate': 0.01 * nrm(ks[16], (DEPTH, N_EXPERTS, D_EXPERT)),
        'w_up': nrm(ks[17], (DEPTH, N_EXPERTS, D_MODEL, D_EXPERT)) * D_MODEL ** -0.5 * DEEPNORM_BETA,
        'b_up': 0.01 * nrm(ks[18], (DEPTH, N_EXPERTS, D_EXPERT)),
        'w_down': nrm(ks[19], (DEPTH, N_EXPERTS, D_EXPERT, D_MODEL)) * D_EXPERT ** -0.5 * DEEPNORM_BETA,
        'b_down': 0.01 * nrm(ks[20], (DEPTH, N_EXPERTS, D_MODEL)),
        'ln2_g': 1.0 + 0.02 * nrm(ks[21], (DEPTH, D_MODEL)),
        'ln2_b': 0.02 * nrm(ks[22], (DEPTH, D_MODEL)),
    }


def reference(x, w_in, hg_lower_bound, hg_norm_w, conv_w, conv_b, dt_bias, a_log, d_skip, ssd_norm_w, w_out,
              ln1_g, ln1_b, router_w, router_b, w_gate, b_gate, w_up, b_up, w_down, b_down, ln2_g, ln2_b):
    lb_table = jnp.cumsum(jax.nn.softmax(hg_lower_bound.astype(jnp.float32), axis=0), axis=0)
    for l in range(DEPTH):
        proj = x @ w_in[l]
        q, f, i, g, z, xbc, dt = jnp.split(proj, SPLITS, axis=-1)
        o_hg = hgrn2_mixer(q, f, i, g, lb_table[l], hg_norm_w[l])
        o_ssd = ssd_mixer(z, xbc, dt, conv_w[l], conv_b[l], dt_bias[l], a_log[l], d_skip[l], ssd_norm_w[l])
        mix = jnp.concatenate([o_hg, o_ssd], axis=-1).astype(x.dtype) @ w_out[l]
        x = layer_norm(DEEPNORM_ALPHA * x + mix, ln1_g[l], ln1_b[l])
        ffn = moe_ffn(x, router_w[l], router_b[l], w_gate[l], b_gate[l], w_up[l], b_up[l], w_down[l], b_down[l])
        x = layer_norm(DEEPNORM_ALPHA * x + ffn, ln2_g[l], ln2_b[l])
    return x
```

```cpp
#include <hip/hip_runtime.h>
#include <hip/hip_bf16.h>
#include <stdint.h>

namespace {
constexpr int T_ = 16384, D_ = 1024, SEQ = 4096;
constexpr int NIN = 3592;
constexpr int C_Q = 0, C_F = 512, C_I = 1024, C_G = 1536, C_Z = 2048, C_XBC = 2560, C_DT = 3584;
constexpr int NE = 32;
constexpr float ALPHA = 1.189207115002721f;
constexpr float LN_EPS = 1e-5f, RMS_EPS = 1e-5f;
constexpr size_t MiB = 1u << 20;

typedef unsigned short bf16_t;
__device__ __forceinline__ float bf2f(bf16_t v) { return __uint_as_float(((unsigned)v) << 16); }
__device__ __forceinline__ bf16_t f2bf(float f) { unsigned u = __float_as_uint(f); return (bf16_t)((u + 0x7fffu + ((u >> 16) & 1u)) >> 16); }
__device__ __forceinline__ float sigmoidf_(float x) { return 1.f / (1.f + __expf(-x)); }
__device__ __forceinline__ float siluf_(float x) { return x * sigmoidf_(x); }
__device__ __forceinline__ float softplusf_(float x) { return fmaxf(x, 0.f) + log1pf(__expf(-fabsf(x))); }

template <class AL, class BL>
__device__ __forceinline__ void gemm_tile(AL aload, BL bload, int K, float (&acc)[4][4], float (*As)[68], float (*Bs)[68]) {
    const int tid = threadIdx.x, ty = tid >> 4, tx = tid & 15;
    const int ar = tid >> 2, ak = (tid & 3) * 4;
    const int bk = tid >> 4, bc = (tid & 15) * 4;
#pragma unroll
    for (int i = 0; i < 4; ++i)
#pragma unroll
        for (int j = 0; j < 4; ++j) acc[i][j] = 0.f;
    for (int k0 = 0; k0 < K; k0 += 16) {
        const float4 av = aload(ar, k0 + ak);
        const float4 bv = bload(k0 + bk, bc);
        __syncthreads();
        As[ak + 0][ar] = av.x; As[ak + 1][ar] = av.y; As[ak + 2][ar] = av.z; As[ak + 3][ar] = av.w;
        *(float4*)&Bs[bk][bc] = bv;
        __syncthreads();
#pragma unroll
        for (int k = 0; k < 16; ++k) {
            const float4 a = *(const float4*)&As[k][ty * 4];
            const float4 b = *(const float4*)&Bs[k][tx * 4];
            const float aa[4] = {a.x, a.y, a.z, a.w}, bb[4] = {b.x, b.y, b.z, b.w};
#pragma unroll
            for (int i = 0; i < 4; ++i)
#pragma unroll
                for (int j = 0; j < 4; ++j) acc[i][j] += aa[i] * bb[j];
        }
    }
}

__global__ __launch_bounds__(256) void k_gemm_plain(const float* __restrict__ A, const float* __restrict__ B, float* __restrict__ C, int M, int N, int K) {
    __shared__ float As[16][68], Bs[16][68];
    const int m0 = blockIdx.y * 64, n0 = blockIdx.x * 64;
    float acc[4][4];
    auto al = [&](int r, int k) { return *(const float4*)(A + (size_t)(m0 + r) * K + k); };
    auto bl = [&](int k, int c) { return (n0 + c < N) ? *(const float4*)(B + (size_t)k * N + n0 + c) : make_float4(0.f, 0.f, 0.f, 0.f); };
    gemm_tile(al, bl, K, acc, As, Bs);
    const int ty = threadIdx.x >> 4, tx = threadIdx.x & 15;
    if (n0 + tx * 4 < N) {
#pragma unroll
        for (int i = 0; i < 4; ++i) *(float4*)(C + (size_t)(m0 + ty * 4 + i) * N + n0 + tx * 4) = make_float4(acc[i][0], acc[i][1], acc[i][2], acc[i][3]);
    }
}

__global__ __launch_bounds__(256) void k_prep(const float* __restrict__ proj, const float* __restrict__ conv_w, const float* __restrict__ conv_b,
                                              const float* __restrict__ dt_bias, float* __restrict__ xc, float* __restrict__ dtv) {
    const int t = blockIdx.x, l = t % SEQ;
    for (int ch = threadIdx.x; ch < 1024; ch += 256) {
        float s = conv_b[ch];
#pragma unroll
        for (int j = 0; j < 4; ++j) { const int ll = l - 3 + j; if (ll >= 0) s += conv_w[j * 1024 + ch] * proj[(size_t)(t - 3 + j) * NIN + C_XBC + ch]; }
        xc[(size_t)t * 1024 + ch] = siluf_(s);
    }
    if (threadIdx.x < 8) dtv[t * 8 + threadIdx.x] = softplusf_(proj[(size_t)t * NIN + C_DT + threadIdx.x] + dt_bias[threadIdx.x]);
}

__global__ __launch_bounds__(512) void k_hgrn(const float* __restrict__ proj, const float* __restrict__ lbraw, float* __restrict__ ohg) {
    __shared__ float sq[2][128], sf[2][128], spart[2][4][128];
    const int bh = blockIdx.x, b = bh >> 2, h = bh & 3;
    const int tid = threadIdx.x, kg = tid >> 7, v = tid & 127;
    float lb = 0.f;
    if (tid < 128) { const float a0 = lbraw[h * 128 + tid], a1 = lbraw[512 + h * 128 + tid]; const float m = fmaxf(a0, a1); const float e0 = __expf(a0 - m), e1 = __expf(a1 - m); lb = e0 / (e0 + e1); }
    float S[32];
#pragma unroll
    for (int j = 0; j < 32; ++j) S[j] = 0.f;
    const float* base = proj + (size_t)b * SEQ * NIN + h * 128;
    float nq = 0.f, nf = 0.f, nv;
    if (tid < 128) { nq = base[C_Q + tid]; nf = base[C_F + tid]; }
    nv = base[C_I + v];
    for (int t = 0; t < SEQ; ++t) {
        const int buf = t & 1;
        const float cq = nq, cf = nf, cv = nv;
        if (t + 1 < SEQ) { const float* nb = base + (size_t)(t + 1) * NIN; if (tid < 128) { nq = nb[C_Q + tid]; nf = nb[C_F + tid]; } nv = nb[C_I + v]; }
        if (tid < 128) { sq[buf][tid] = siluf_(cq); sf[buf][tid] = lb + (1.f - lb) * sigmoidf_(cf); }
        __syncthreads();
        float acc = 0.f;
#pragma unroll
        for (int j = 0; j < 32; ++j) { const float f = sf[buf][kg * 32 + j]; S[j] = f * S[j] + (1.f - f) * cv; acc += sq[buf][kg * 32 + j] * S[j]; }
        spart[buf][kg][v] = acc;
        __syncthreads();
        if (kg == 0) ohg[((size_t)b * SEQ + t) * 512 + h * 128 + v] = (spart[buf][0][v] + spart[buf][1][v]) + (spart[buf][2][v] + spart[buf][3][v]);
    }
}

__global__ __launch_bounds__(512) void k_ssd(const float* __restrict__ xc, const float* __restrict__ dtv, const float* __restrict__ a_log, const float* __restrict__ d_skip, float* __restrict__ yssd) {
    const int bh = blockIdx.x, b = bh >> 3, h = bh & 7, g = h >> 2;
    const int tid = threadIdx.x, p = tid >> 3, ng = tid & 7;
    const float A = -__expf(a_log[h]), Dh = d_skip[h];
    float st[16];
#pragma unroll
    for (int j = 0; j < 16; ++j) st[j] = 0.f;
    for (int t = 0; t < SEQ; ++t) {
        const size_t row = (size_t)b * SEQ + t;
        const float* xr = xc + row * 1024;
        const float x = xr[h * 64 + p], dt = dtv[row * 8 + h];
        const float dA = __expf(dt * A), xdt = x * dt;
        const float4* Bp = (const float4*)(xr + 512 + g * 128 + ng * 16);
        const float4* Cp = (const float4*)(xr + 768 + g * 128 + ng * 16);
        float y = 0.f;
#pragma unroll
        for (int q = 0; q < 4; ++q) {
            const float4 bq = Bp[q], cq = Cp[q];
            st[q * 4 + 0] = dA * st[q * 4 + 0] + xdt * bq.x; y += st[q * 4 + 0] * cq.x;
            st[q * 4 + 1] = dA * st[q * 4 + 1] + xdt * bq.y; y += st[q * 4 + 1] * cq.y;
            st[q * 4 + 2] = dA * st[q * 4 + 2] + xdt * bq.z; y += st[q * 4 + 2] * cq.z;
            st[q * 4 + 3] = dA * st[q * 4 + 3] + xdt * bq.w; y += st[q * 4 + 3] * cq.w;
        }
        y += __shfl_xor(y, 1); y += __shfl_xor(y, 2); y += __shfl_xor(y, 4);
        if (ng == 0) yssd[row * 512 + h * 64 + p] = y + Dh * x;
    }
}

template <int NV>
__device__ __forceinline__ void block_sum128(float (&v)[NV], float (*red)[NV]) {
#pragma unroll
    for (int i = 0; i < NV; ++i) {
#pragma unroll
        for (int o = 1; o < 64; o <<= 1) v[i] += __shfl_xor(v[i], o);
    }
    const int w = threadIdx.x >> 6;
    if ((threadIdx.x & 63) == 0) {
#pragma unroll
        for (int i = 0; i < NV; ++i) red[w][i] = v[i];
    }
    __syncthreads();
#pragma unroll
    for (int i = 0; i < NV; ++i) v[i] = red[0][i] + red[1][i];
    __syncthreads();
}

__global__ __launch_bounds__(128) void k_mixnorm(const float* __restrict__ proj, const float* __restrict__ ohg, const float* __restrict__ yssd,
                                                 const float* __restrict__ hg_norm_w, const float* __restrict__ ssd_norm_w, float* __restrict__ mix) {
    __shared__ float red[2][6];
    const int t = blockIdx.x, j = threadIdx.x;
    const float* pr = proj + (size_t)t * NIN;
    float o[4], y[4], s[6];
#pragma unroll
    for (int q = 0; q < 4; ++q) { o[q] = ohg[(size_t)t * 512 + q * 128 + j]; y[q] = yssd[(size_t)t * 512 + q * 128 + j] * siluf_(pr[C_Z + q * 128 + j]); }
    s[0] = o[0] * o[0]; s[1] = o[1] * o[1]; s[2] = o[2] * o[2]; s[3] = o[3] * o[3];
    s[4] = y[0] * y[0] + y[1] * y[1]; s[5] = y[2] * y[2] + y[3] * y[3];
    block_sum128<6>(s, red);
#pragma unroll
    for (int q = 0; q < 4; ++q) {
        const float r = rsqrtf(s[q] * (1.f / 128.f) + RMS_EPS);
        mix[(size_t)t * 1024 + q * 128 + j] = o[q] * r * hg_norm_w[j] * siluf_(pr[C_G + q * 128 + j]);
        const float r2 = rsqrtf(s[4 + (q >> 1)] * (1.f / 256.f) + RMS_EPS);
        mix[(size_t)t * 1024 + 512 + q * 128 + j] = y[q] * r2 * ssd_norm_w[q * 128 + j];
    }
}

template <bool ADD_SLOTS>
__global__ __launch_bounds__(128) void k_ln(const float* __restrict__ xres, const float* __restrict__ add, const bf16_t* __restrict__ yslot,
                                            const float* __restrict__ g, const float* __restrict__ bta, float* __restrict__ out) {
    __shared__ float red[2][1];
    const int t = blockIdx.x, j = threadIdx.x;
    float v[8];
#pragma unroll
    for (int q = 0; q < 8; ++q) {
        const int c = q * 128 + j;
        float a;
        if (ADD_SLOTS) { a = 0.f;
#pragma unroll
            for (int k = 0; k < 4; ++k) a += bf2f(yslot[((size_t)t * 4 + k) * 1024 + c]); }
        else a = add[(size_t)t * 1024 + c];
        v[q] = ALPHA * xres[(size_t)t * 1024 + c] + a;
    }
    float s[1]; s[0] = 0.f;
#pragma unroll
    for (int q = 0; q < 8; ++q) s[0] += v[q];
    block_sum128<1>(s, red);
    const float mean = s[0] * (1.f / 1024.f);
    s[0] = 0.f;
#pragma unroll
    for (int q = 0; q < 8; ++q) { const float d = v[q] - mean; s[0] += d * d; }
    block_sum128<1>(s, red);
    const float rstd = rsqrtf(s[0] * (1.f / 1024.f) + LN_EPS);
#pragma unroll
    for (int q = 0; q < 8; ++q) { const int c = q * 128 + j; out[(size_t)t * 1024 + c] = (v[q] - mean) * rstd * g[c] + bta[c]; }
}

__global__ __launch_bounds__(256) void k_router(const float* __restrict__ x1, const float* __restrict__ rw, const float* __restrict__ rb,
                                                int* __restrict__ cnt, int* __restrict__ tokl, int* __restrict__ slotl, float* __restrict__ gatel) {
    const int tl = threadIdx.x >> 5, e = threadIdx.x & 31, tok = blockIdx.x * 8 + tl;
    const float* xr = x1 + (size_t)tok * 1024;
    float acc = 0.f;
    for (int k = 0; k < 1024; k += 4) {
        const float4 xv = *(const float4*)(xr + k);
        acc += xv.x * rw[(k + 0) * 32 + e]; acc += xv.y * rw[(k + 1) * 32 + e]; acc += xv.z * rw[(k + 2) * 32 + e]; acc += xv.w * rw[(k + 3) * 32 + e];
    }
    acc += rb[e];
    float val = acc; float topv[4]; int tope[4];
#pragma unroll
    for (int r = 0; r < 4; ++r) {
        float bv = val; int bi = e;
#pragma unroll
        for (int o = 16; o >= 1; o >>= 1) { const float ov = __shfl_xor(bv, o, 32); const int oi = __shfl_xor(bi, o, 32); if (ov > bv || (ov == bv && oi < bi)) { bv = ov; bi = oi; } }
        topv[r] = bv; tope[r] = bi;
        if (e == bi) val = -INFINITY;
    }
    const float m = topv[0];
    const float e0 = __expf(topv[0] - m), e1 = __expf(topv[1] - m), e2 = __expf(topv[2] - m), e3 = __expf(topv[3] - m);
    const float inv = 1.f / (e0 + e1 + e2 + e3);
    if (e < 4) {
        const int ex = e == 0 ? tope[0] : e == 1 ? tope[1] : e == 2 ? tope[2] : tope[3];
        const float gv = (e == 0 ? e0 : e == 1 ? e1 : e == 2 ? e2 : e3) * inv;
        const int pos = atomicAdd(&cnt[ex], 1);
        tokl[ex * T_ + pos] = tok; slotl[ex * T_ + pos] = tok * 4 + e; gatel[ex * T_ + pos] = gv;
    }
}

__device__ __forceinline__ bool find_tile(const int* cnt, int mt, int& e, int& lt, int& pstart, int& n) {
    int acc_t = 0, acc_r = 0;
    for (int i = 0; i < NE; ++i) { const int c = cnt[i], nt = (c + 63) >> 6; if (mt < acc_t + nt) { e = i; lt = mt - acc_t; pstart = acc_r; n = c; return true; } acc_t += nt; acc_r += c; }
    return false;
}

__global__ __launch_bounds__(256) void k_moe1(const float* __restrict__ x1, const int* __restrict__ cnt, const int* __restrict__ tokl,
                                              const float* __restrict__ wg, const float* __restrict__ bg, const float* __restrict__ wu, const float* __restrict__ bu,
                                              bf16_t* __restrict__ hbuf) {
    __shared__ float As[16][68], Bs[16][68];
    __shared__ int stok[64];
    int e, lt, pstart, n;
    if (!find_tile(cnt, blockIdx.y, e, lt, pstart, n)) return;
    const int n0 = blockIdx.x * 64, r0 = lt * 64;
    if (threadIdx.x < 64) { const int r = r0 + threadIdx.x; stok[threadIdx.x] = tokl[e * T_ + (r < n ? r : n - 1)]; }
    __syncthreads();
    float ag[4][4], au[4][4];
    auto al = [&](int r, int k) { return *(const float4*)(x1 + (size_t)stok[r] * 1024 + k); };
    const float* Wg = wg + (size_t)e * 1024 * 1024; const float* Wu = wu + (size_t)e * 1024 * 1024;
    auto blg = [&](int k, int c) { return *(const float4*)(Wg + (size_t)k * 1024 + n0 + c); };
    auto blu = [&](int k, int c) { return *(const float4*)(Wu + (size_t)k * 1024 + n0 + c); };
    gemm_tile(al, blg, 1024, ag, As, Bs);
    gemm_tile(al, blu, 1024, au, As, Bs);
    const int ty = threadIdx.x >> 4, tx = threadIdx.x & 15;
#pragma unroll
    for (int i = 0; i < 4; ++i) {
        const int r = r0 + ty * 4 + i; if (r >= n) continue;
#pragma unroll
        for (int j = 0; j < 4; ++j) {
            const int c = n0 + tx * 4 + j;
            const float hg = fminf(ag[i][j] + bg[e * 1024 + c], 7.f);
            const float hu = fminf(fmaxf(au[i][j] + bu[e * 1024 + c], -7.f), 7.f);
            hbuf[(size_t)(pstart + r) * 1024 + c] = f2bf((hu + 1.f) * (hg * sigmoidf_(1.702f * hg)));
        }
    }
}

__global__ __launch_bounds__(256) void k_moe2(const bf16_t* __restrict__ hbuf, const int* __restrict__ cnt, const int* __restrict__ slotl, const float* __restrict__ gatel,
                                              const float* __restrict__ wd, const float* __restrict__ bd, bf16_t* __restrict__ yslot) {
    __shared__ float As[16][68], Bs[16][68];
    int e, lt, pstart, n;
    if (!find_tile(cnt, blockIdx.y, e, lt, pstart, n)) return;
    const int n0 = blockIdx.x * 64, r0 = lt * 64;
    float acc[4][4];
    auto al = [&](int r, int k) { int rr = r0 + r; if (rr >= n) rr = n - 1; const bf16_t* p = hbuf + (size_t)(pstart + rr) * 1024 + k; return make_float4(bf2f(p[0]), bf2f(p[1]), bf2f(p[2]), bf2f(p[3])); };
    const float* Wd = wd + (size_t)e * 1024 * 1024;
    auto bl = [&](int k, int c) { return *(const float4*)(Wd + (size_t)k * 1024 + n0 + c); };
    gemm_tile(al, bl, 1024, acc, As, Bs);
    const int ty = threadIdx.x >> 4, tx = threadIdx.x & 15;
#pragma unroll
    for (int i = 0; i < 4; ++i) {
        const int r = r0 + ty * 4 + i; if (r >= n) continue;
        const int slot = slotl[e * T_ + r]; const float gv = gatel[e * T_ + r];
#pragma unroll
        for (int j = 0; j < 4; ++j) { const int c = n0 + tx * 4 + j; yslot[(size_t)slot * 1024 + c] = f2bf((acc[i][j] + bd[e * 1024 + c]) * gv); }
    }
}
}

extern "C" void kernel_launch(void* const* d_in, const int* in_sizes, int n_in, void* d_out, int out_size, void* d_ws, size_t ws_size, hipStream_t stream) {
    const float* x = (const float*)d_in[0];      const float* w_in = (const float*)d_in[1];   const float* lbraw = (const float*)d_in[2];
    const float* hg_norm_w = (const float*)d_in[3]; const float* conv_w = (const float*)d_in[4]; const float* conv_b = (const float*)d_in[5];
    const float* dt_bias = (const float*)d_in[6]; const float* a_log = (const float*)d_in[7];  const float* d_skip = (const float*)d_in[8];
    const float* ssd_norm_w = (const float*)d_in[9]; const float* w_out = (const float*)d_in[10]; const float* ln1_g = (const float*)d_in[11];
    const float* ln1_b = (const float*)d_in[12];  const float* router_w = (const float*)d_in[13]; const float* router_b = (const float*)d_in[14];
    const float* w_gate = (const float*)d_in[15]; const float* b_gate = (const float*)d_in[16]; const float* w_up = (const float*)d_in[17];
    const float* b_up = (const float*)d_in[18];   const float* w_down = (const float*)d_in[19]; const float* b_down = (const float*)d_in[20];
    const float* ln2_g = (const float*)d_in[21];  const float* ln2_b = (const float*)d_in[22];
    float* out = (float*)d_out;
    char* ws = (char*)d_ws;
    float* proj = (float*)(ws);
    float* xc = (float*)(ws + 225 * MiB);
    float* mixproj = xc;
    float* dtv = (float*)(ws + 289 * MiB);
    float* ohg = (float*)(ws + 290 * MiB);
    float* yssd = (float*)(ws + 322 * MiB);
    float* mix = (float*)(ws + 354 * MiB);
    float* x1 = (float*)(ws + 418 * MiB);
    int* tokl = (int*)(ws + 482 * MiB); int* slotl = (int*)(ws + 484 * MiB); float* gatel = (float*)(ws + 486 * MiB);
    int* cnt = (int*)(ws + 488 * MiB);
    bf16_t* hbuf = (bf16_t*)(ws);
    bf16_t* yslot = (bf16_t*)(ws + 128 * MiB);

    hipMemsetAsync(cnt, 0, 256, stream);
    k_gemm_plain<<<dim3((NIN + 63) / 64, T_ / 64), 256, 0, stream>>>(x, w_in, proj, T_, NIN, D_);
    k_prep<<<T_, 256, 0, stream>>>(proj, conv_w, conv_b, dt_bias, xc, dtv);
    k_hgrn<<<16, 512, 0, stream>>>(proj, lbraw, ohg);
    k_ssd<<<32, 512, 0, stream>>>(xc, dtv, a_log, d_skip, yssd);
    k_mixnorm<<<T_, 128, 0, stream>>>(proj, ohg, yssd, hg_norm_w, ssd_norm_w, mix);
    k_gemm_plain<<<dim3(D_ / 64, T_ / 64), 256, 0, stream>>>(mix, w_out, mixproj, T_, D_, D_);
    k_ln<false><<<T_, 128, 0, stream>>>(x, mixproj, nullptr, ln1_g, ln1_b, x1);
    k_router<<<T_ / 8, 256, 0, stream>>>(x1, router_w, router_b, cnt, tokl, slotl, gatel);
    k_moe1<<<dim3(16, 1056), 256, 0, stream>>>(x1, cnt, tokl, w_gate, b_gate, w_up, b_up, hbuf);
    k_moe2<<<dim3(16, 1056), 256, 0, stream>>>(hbuf, cnt, slotl, gatel, w_down, b_down, yslot);
    k_ln<true><<<T_, 128, 0, stream>>>(x1, nullptr, yslot, ln2_g, ln2_b, out);
}
```
